# Optimizing an MI355X kernel written in HIP

```python
import math
import jax, jax.numpy as jnp
from jax import lax
import numpy as np

D_MODEL = 1024
BATCH = 4
SEQ = 8192
DEPTH = 1

RET_HEADS = 4
RET_QK_DIM = 64
RET_V_DIM = 128
RET_CHUNK = 128
RET_WIDTH = RET_HEADS * RET_V_DIM
MOBA_HEADS = 8
MOBA_HEAD_DIM = 64
MOBA_WIDTH = MOBA_HEADS * MOBA_HEAD_DIM
MOBA_BLOCK = 256
MOBA_TOPK = 3
MOBA_QBLOCK = 64
REL_BUCKETS = 32
REL_MAX_DIST = 128
D_FF = -(-8 * D_MODEL // (3 * 256)) * 256
MIX_WIDTH = RET_WIDTH + MOBA_WIDTH
IN_COLS = 2 * RET_HEADS * RET_QK_DIM + 2 * RET_WIDTH + 3 * MOBA_WIDTH
EPS = 1e-6
ROPE_BASE = 10000.0

kernel_name = "hybrid_retention_moba_sandwich_block"


def rmsnorm(x, g):
    xf = x.astype(jnp.float32)
    y = xf * lax.rsqrt(jnp.mean(xf * xf, axis=-1, keepdims=True) + EPS)
    return (y * g.astype(jnp.float32)).astype(x.dtype)


def head_rmsnorm(x):
    xf = x.astype(jnp.float32)
    return (xf * lax.rsqrt(jnp.mean(xf * xf, axis=-1, keepdims=True) + EPS)).astype(x.dtype)


def rotary(x):
    s, d = x.shape[1], x.shape[-1]
    half = d // 2
    inv_freq = ROPE_BASE ** (-jnp.arange(half, dtype=jnp.float32) / half)
    ang = jnp.arange(s, dtype=jnp.float32)[:, None] * inv_freq[None, :]
    cos = jnp.cos(ang)[None, :, None, :]
    sin = jnp.sin(ang)[None, :, None, :]
    xf = x.astype(jnp.float32)
    x1, x2 = xf[..., :half], xf[..., half:]
    return jnp.concatenate([x1 * cos - x2 * sin, x2 * cos + x1 * sin], axis=-1).astype(x.dtype)


def t5_bucket(rel):
    n = jnp.maximum(rel, 0)
    max_exact = REL_BUCKETS // 2
    is_small = n < max_exact
    nf = jnp.maximum(n, 1).astype(jnp.float32)
    large = max_exact + (jnp.log(nf / max_exact) / math.log(REL_MAX_DIST / max_exact)
                         * (REL_BUCKETS - max_exact)).astype(jnp.int32)
    large = jnp.minimum(large, REL_BUCKETS - 1)
    return jnp.where(is_small, n, large)


def retention(q, k, v):
    b, s, h, dk = q.shape
    dv = v.shape[-1]
    c = RET_CHUNK
    n = s // c

    def to_chunks(t):
        return t.astype(jnp.float32).reshape(b, n, c, h, t.shape[-1]).transpose(1, 0, 3, 2, 4)

    qc, kc, vc = to_chunks(q), to_chunks(k), to_chunks(v)
    log_gamma = jnp.log1p(-jnp.exp(jnp.linspace(math.log(1.0 / 32), math.log(1.0 / 512), RET_HEADS)))
    log_gamma = log_gamma.astype(jnp.float32)
    idx = jnp.arange(c, dtype=jnp.float32)
    diff = idx[:, None] - idx[None, :]
    intra_decay = jnp.where(diff >= 0, jnp.exp(jnp.maximum(diff, 0.0)[None] * log_gamma[:, None, None]), 0.0)
    q_decay = jnp.exp((idx + 1.0)[None, :] * log_gamma[:, None])
    k_decay = jnp.exp((c - 1.0 - idx)[None, :] * log_gamma[:, None])
    chunk_decay = jnp.exp(c * log_gamma)

    def step(state, inp):
        qi, ki, vi = inp
        scores = jnp.einsum('bhid,bhjd->bhij', qi, ki) * intra_decay[None]
        o = jnp.einsum('bhij,bhje->bhie', scores, vi)
        o = o + jnp.einsum('bhid,bhde->bhie', qi * q_decay[None, :, :, None], state)
        new_state = state * chunk_decay[None, :, None, None] + jnp.einsum(
            'bhjd,bhje->bhde', ki * k_decay[None, :, :, None], vi)
        return new_state, o

    state0 = jnp.zeros((b, h, dk, dv), jnp.float32)
    _, o = lax.scan(step, state0, (qc, kc, vc))
    return o.transpose(1, 0, 3, 2, 4).reshape(b, s, h, dv).astype(v.dtype)


def moba_attention(q, k, v, rel_bias):
    b, s, h, d = q.shape
    bs = MOBA_BLOCK
    nb = -(-s // bs)
    sp = nb * bs
    pad = sp - s

    def prep(t):
        return jnp.pad(t, ((0, 0), (0, pad), (0, 0), (0, 0))).transpose(0, 2, 1, 3)

    q, k, v = prep(q), prep(k), prep(v)
    kb = k.reshape(b, h, nb, bs, d)
    vb = v.reshape(b, h, nb, bs, d)
    k_mean = jnp.mean(kb.astype(jnp.float32), axis=3)
    gate = jnp.einsum('bhsd,bhnd->bhsn', q.astype(jnp.float32), k_mean)
    q_blk = jnp.arange(sp) // bs
    fully_past = jnp.arange(nb)[None, :] < q_blk[:, None]
    gate = jnp.where(fully_past[None, None], gate, -jnp.inf)
    topk = min(MOBA_TOPK, nb)
    vals, sel = lax.top_k(gate, topk)
    valid = jnp.isfinite(vals)
    sel = jnp.where(valid, sel, 0)

    bias_t = rel_bias.T.astype(jnp.float32)
    scale = d ** -0.5
    bi = jnp.arange(b)[:, None, None, None]
    hi = jnp.arange(h)[None, :, None, None]
    kidx = jnp.arange(bs)

    def query_block(start):
        qs = lax.dynamic_slice_in_dim(q, start, MOBA_QBLOCK, axis=2)
        sel_b = lax.dynamic_slice_in_dim(sel, start, MOBA_QBLOCK, axis=2)
        valid_b = lax.dynamic_slice_in_dim(valid, start, MOBA_QBLOCK, axis=2)
        qp = start + jnp.arange(MOBA_QBLOCK)
        k_sel = kb[bi, hi, sel_b]
        v_sel = vb[bi, hi, sel_b]
        s_sel = jnp.einsum('bhqd,bhqnkd->bhqnk', qs, k_sel).astype(jnp.float32) * scale
        kp_sel = sel_b[..., None] * bs + kidx
        bias_sel = bias_t[hi[..., None], t5_bucket(qp[None, None, :, None, None] - kp_sel)]
        s_sel = jnp.where(valid_b[..., None], s_sel + bias_sel, -jnp.inf)
        own = start // bs
        k_own = lax.dynamic_index_in_dim(kb, own, axis=2, keepdims=False)
        v_own = lax.dynamic_index_in_dim(vb, own, axis=2, keepdims=False)
        s_own = jnp.einsum('bhqd,bhkd->bhqk', qs, k_own).astype(jnp.float32) * scale
        rel_own = qp[:, None] - (own * bs + kidx)[None, :]
        bias_own = bias_t[:, t5_bucket(rel_own)]
        s_own = jnp.where(rel_own[None, None] >= 0, s_own + bias_own[None], -jnp.inf)
        logits = jnp.concatenate([s_sel.reshape(b, h, MOBA_QBLOCK, topk * bs), s_own], axis=-1)
        p = jax.nn.softmax(logits, axis=-1).astype(v.dtype)
        p_sel = p[..., :topk * bs].reshape(b, h, MOBA_QBLOCK, topk, bs)
        p_own = p[..., topk * bs:]
        return (jnp.einsum('bhqnk,bhqnkd->bhqd', p_sel, v_sel)
                + jnp.einsum('bhqk,bhkd->bhqd', p_own, v_own))

    starts = jnp.arange(sp // MOBA_QBLOCK) * MOBA_QBLOCK
    o = lax.map(query_block, starts)
    o = o.transpose(1, 2, 0, 3, 4).reshape(b, h, sp, d)[:, :, :s]
    return o.transpose(0, 2, 1, 3)


def setup_inputs(seed: int = 0) -> dict:
    key = jax.random.key(seed)
    ks = jax.random.split(key, 12)
    f32 = jnp.float32

    def w(k, shape, fan_in):
        return jax.random.normal(k, shape, f32) * fan_in ** -0.5

    def gain(k):
        return 1.0 + 0.02 * jax.random.normal(k, (DEPTH, D_MODEL), f32)

    return {
        "x": jax.random.normal(ks[0], (BATCH, SEQ, D_MODEL), f32),
        "w_in": w(ks[1], (DEPTH, D_MODEL, IN_COLS), D_MODEL),
        "w_out": w(ks[2], (DEPTH, MIX_WIDTH, D_MODEL), MIX_WIDTH),
        "pre_mix_norm": gain(ks[3]),
        "post_mix_norm": gain(ks[4]),
        "pre_ffn_norm": gain(ks[5]),
        "post_ffn_norm": gain(ks[6]),
        "rel_bias": 0.5 * jax.random.normal(ks[7], (REL_BUCKETS, MOBA_HEADS), f32),
        "w_gate": w(ks[8], (DEPTH, D_MODEL, D_FF), D_MODEL),
        "w_up": w(ks[9], (DEPTH, D_MODEL, D_FF), D_MODEL),
        "w_down": w(ks[10], (DEPTH, D_FF, D_MODEL), D_FF),
    }


def reference(x, w_in, w_out, pre_mix_norm, post_mix_norm, pre_ffn_norm, post_ffn_norm,
              rel_bias, w_gate, w_up, w_down):
    b, s, _ = x.shape
    sizes = [RET_HEADS * RET_QK_DIM, RET_HEADS * RET_QK_DIM, RET_WIDTH, RET_WIDTH,
             MOBA_WIDTH, MOBA_WIDTH, MOBA_WIDTH]
    split_at = np.cumsum(sizes)[:-1].tolist()
    for layer in range(DEPTH):
        h = rmsnorm(x, pre_mix_norm[layer])
        proj = h @ w_in[layer]
        rq, rk, rv, rg, mq, mk, mv = jnp.split(proj, split_at, axis=-1)
        rq = rotary(rq.reshape(b, s, RET_HEADS, RET_QK_DIM))
        rk = rotary(rk.reshape(b, s, RET_HEADS, RET_QK_DIM)) * (RET_QK_DIM ** -0.5)
        rv = rv.reshape(b, s, RET_HEADS, RET_V_DIM)
        ret = head_rmsnorm(retention(rq, rk, rv)).reshape(b, s, RET_WIDTH)
        ret = jax.nn.silu(rg) * ret
        moba = moba_attention(mq.reshape(b, s, MOBA_HEADS, MOBA_HEAD_DIM),
                              mk.reshape(b, s, MOBA_HEADS, MOBA_HEAD_DIM),
                              mv.reshape(b, s, MOBA_HEADS, MOBA_HEAD_DIM),
                              rel_bias).reshape(b, s, MOBA_WIDTH)
        mix = jnp.concatenate([ret, moba], axis=-1) @ w_out[layer]
        x = x + rmsnorm(mix, post_mix_norm[layer])
        h = rmsnorm(x, pre_ffn_norm[layer])
        f = (jax.nn.silu(h @ w_gate[layer]) * (h @ w_up[layer])) @ w_down[layer]
        x = x + rmsnorm(f, post_ffn_norm[layer])
    return x
```

```cpp
#include <hip/hip_runtime.h>
#include <cstdio>
#include <cstdint>
namespace pg8 {
#define PG8_LAS __attribute__((address_space(3)))
typedef unsigned short bf16_t;
typedef short bf16x8 __attribute__((ext_vector_type(8)));
typedef float f32x4 __attribute__((ext_vector_type(4)));
typedef unsigned u32x4 __attribute__((ext_vector_type(4)));
constexpr int BM = 256, BK = 64, HALF = 128, HTB = HALF * BK * 2  , STAGE_BYTES = 8 * HTB, NXCD = 8, WGM = 8;

__host__ __device__ __forceinline__ int lds_byte(int r, int c) { const int st = (r >> 4) * 2 + (c >> 5), rr = r & 15, cc = c & 31, ob = rr * 64 + cc * 2; return st * 1024 + (ob ^ (((ob >> 9) & 1) << 5)); }
__host__ __device__ __forceinline__ void stage_rc(int b, int& R, int& C) { const int st = b / 1024, sb = b % 1024, swz = sb ^ (((sb >> 9) & 1) << 5); R = (st >> 1) * 16 + swz / 64; C = (st & 1) * 32 + (swz % 64) / 2; }
__host__ __device__ __forceinline__ int perm32(int rho) { const int n = rho >> 4, i = rho & 15; return 8 * (i >> 2) + 4 * n + (i & 3); }

struct Unit { int pm, pn; };
struct Gemm { const bf16_t* A; const bf16_t* Bt; int M, N, K; };

struct StaticOrder {
    int nM, nN, nwg, G, c;
    __host__ __device__ void init(int M, int N, int G_, int c_) { nM = M / BM; nN = N / BM; nwg = nM * nN; G = G_; c = c_; }
    __host__ __device__ bool next(int i, Unit& u) const {
        const long L = (long)i * G + c; if (L >= nwg) return false;
        int wgid = (int)L; { const int q = nwg / NXCD, r = nwg % NXCD, xcd = wgid % NXCD, off = wgid / NXCD; wgid = (xcd < r ? xcd * (q + 1) : r * (q + 1) + (xcd - r) * q) + off; }
        const int nig = WGM * nN, gid = wgid / nig, fm = gid * WGM, gsz = (nM - fm) < WGM ? (nM - fm) : WGM;
        u.pm = fm + ((wgid % nig) % gsz); u.pn = (wgid % nig) / gsz; return true;
    }
    __device__ __forceinline__ void a_ready(const Unit&) const {}
    __device__ __forceinline__ void done(const Unit&) const {}
};

__device__ __forceinline__ unsigned cvt_pk_bf16(float lo, float hi) { unsigned r; asm volatile("v_cvt_pk_bf16_f32 %0, %1, %2" : "=v"(r) : "v"(lo), "v"(hi)); return r; }
typedef float f32x2 __attribute__((ext_vector_type(2)));
typedef unsigned u32x2 __attribute__((ext_vector_type(2)));
struct EpiPlain {
    static constexpr bool PERM = true, AFTER_DRAIN = false;
    bf16_t* O; int ldc;
    __device__ __forceinline__ void operator()(const f32x4 (&acc)[2][2][4][2], const Unit& u, int wr, int wc, int fr, int fq) const {
        const int row0 = u.pm * BM + wr * 64 + fr; const int col0 = u.pn * BM + wc * 32 + 8 * fq;
#pragma unroll
        for (int ai = 0; ai < 2; ++ai)
#pragma unroll
            for (int m = 0; m < 4; ++m) { bf16_t* rowp = O + (size_t)(row0 + ai * HALF + m * 16) * ldc + col0;
#pragma unroll
                for (int bj = 0; bj < 2; ++bj) { const f32x4 v0 = acc[ai][bj][m][0], v1 = acc[ai][bj][m][1];
                    u32x4 w; w.x = cvt_pk_bf16(v0[0], v0[1]); w.y = cvt_pk_bf16(v0[2], v0[3]); w.z = cvt_pk_bf16(v1[0], v1[1]); w.w = cvt_pk_bf16(v1[2], v1[3]);
                    *(u32x4*)(rowp + bj * HALF) = w; } }
    }
};
struct EpiProj {
    static constexpr bool PERM = true, AFTER_DRAIN = false;
    bf16_t* O; int ldc; const float* rope;
    int seq;
    __device__ __forceinline__ void operator()(const f32x4 (&acc)[2][2][4][2], const Unit& u, int wr, int wc, int fr, int fq) const {
        const int row0 = u.pm * BM + wr * 64 + fr; const int col0 = u.pn * BM + wc * 32 + 8 * fq;
        const bool rot = (u.pn < 2);
        const int j0 = 4 * ((4 * wc + fq) & 7);
#pragma unroll
        for (int ai = 0; ai < 2; ++ai)
#pragma unroll
            for (int m = 0; m < 4; ++m) { const int row = row0 + ai * HALF + m * 16; bf16_t* rowp = O + (size_t)row * ldc + col0;
                f32x4 cs = (f32x4){1.f, 1.f, 1.f, 1.f}, sn = (f32x4){0.f, 0.f, 0.f, 0.f};
                if (rot) { const float* rp = rope + (size_t)(row & (seq - 1)) * 64 + j0; cs = *(const f32x4*)rp; sn = *(const f32x4*)(rp + 32); }
#pragma unroll
                for (int bj = 0; bj < 2; ++bj) { f32x4 v0 = acc[ai][bj][m][0], v1 = acc[ai][bj][m][1];
                    if (rot) { const f32x4 a = v0 * cs - v1 * sn, b = v1 * cs + v0 * sn; v0 = a; v1 = b; }
                    u32x4 w; w.x = cvt_pk_bf16(v0[0], v0[1]); w.y = cvt_pk_bf16(v0[2], v0[3]); w.z = cvt_pk_bf16(v1[0], v1[1]); w.w = cvt_pk_bf16(v1[2], v1[3]);
                    *(u32x4*)(rowp + bj * HALF) = w; } }
    }
};
struct EpiSwiGLU {
    static constexpr bool PERM = true, AFTER_DRAIN = false;
    bf16_t* O; int ldc;
    __device__ __forceinline__ void operator()(const f32x4 (&acc)[2][2][4][2], const Unit& u, int wr, int wc, int fr, int fq) const {
        const int row0 = u.pm * BM + wr * 64 + fr; const int col0 = u.pn * (BM / 2) + wc * 16 + 4 * fq;
#pragma unroll
        for (int ai = 0; ai < 2; ++ai)
#pragma unroll
            for (int m = 0; m < 4; ++m) { bf16_t* rowp = O + (size_t)(row0 + ai * HALF + m * 16) * ldc + col0;
#pragma unroll
                for (int bj = 0; bj < 2; ++bj) { const f32x4 g = acc[ai][bj][m][0], up = acc[ai][bj][m][1]; f32x4 o;
#pragma unroll
                    for (int j = 0; j < 4; ++j) { const float e = __builtin_amdgcn_exp2f(g[j] * -1.4426950408889634f); o[j] = g[j] * __builtin_amdgcn_rcpf(1.0f + e) * up[j]; }
                    u32x2 w; w.x = cvt_pk_bf16(o[0], o[1]); w.y = cvt_pk_bf16(o[2], o[3]);
                    *(u32x2*)(rowp + bj * (HALF / 2)) = w; } }
    }
};

template <class Epi, class Sched, bool ALIGN_EPI = false, bool SP2 = false>
__device__ __forceinline__ void gemm_phase(PG8_LAS unsigned char* lds, const Gemm g, const Sched& S, const Epi& E) {
    const int tid = threadIdx.x, wid = __builtin_amdgcn_readfirstlane(tid >> 6), lane = tid & 63, wr = wid >> 2, wc = wid & 3, fr = lane & 15, fq = lane >> 4;
    const int K = g.K, nt = K / BK;
    unsigned voffA[2], voffB[2];
#pragma unroll
    for (int i = 0; i < 2; ++i) { int R, C; stage_rc(tid * 16 + i * 8192, R, C); const int Rb = Epi::PERM ? ((R & ~31) + perm32(R & 31)) : R;
        voffA[i] = (unsigned)(R * K + C) * 2u; voffB[i] = (unsigned)(Rb * K + C) * 2u; }
    const size_t kstep = (size_t)(BK * 2);
    const size_t hstep = (size_t)HALF * K * 2;
    const size_t tstep = 2 * hstep;
    const unsigned ldsw = (unsigned)wid * 1024u;
    const int aoff = lds_byte(wr * 64 + fr, fq * 8), boff = lds_byte(wc * 32 + fr, fq * 8);
#define PG8_SA(b, h) (((b) * 2 + (h)) * HTB)
#define PG8_SB(b, h) ((4 + (b) * 2 + (h)) * HTB)
#define PG8_STAGE(bufoff, gbase, voff) do { _Pragma("unroll") for (int _i = 0; _i < 2; ++_i) \
        __builtin_amdgcn_global_load_lds((const unsigned*)((const char*)(gbase) + (voff)[_i]), (PG8_LAS unsigned*)(lds + (bufoff) + ldsw + _i * 8192), 16, 0, 0); } while (0)
#define PG8_LDA(dst, b, h) do { _Pragma("unroll") for (int m = 0; m < 4; ++m) _Pragma("unroll") for (int k = 0; k < 2; ++k) dst[m][k] = *(const PG8_LAS bf16x8*)(lds + PG8_SA(b, h) + aoff + m * 2048 + k * 1024); } while (0)
#define PG8_LDB(dst, b, h) do { _Pragma("unroll") for (int n = 0; n < 2; ++n) _Pragma("unroll") for (int k = 0; k < 2; ++k) dst[n][k] = *(const PG8_LAS bf16x8*)(lds + PG8_SB(b, h) + boff + n * 2048 + k * 1024); } while (0)
#define PG8_MMA(ai, bj, At, Bt) do { __builtin_amdgcn_s_setprio(1); _Pragma("unroll") for (int m = 0; m < 4; ++m) _Pragma("unroll") for (int n = 0; n < 2; ++n) _Pragma("unroll") for (int k = 0; k < 2; ++k) \
        acc[ai][bj][m][n] = __builtin_amdgcn_mfma_f32_16x16x32_bf16(Bt[n][k], At[m][k], acc[ai][bj][m][n], 0, 0, 0); __builtin_amdgcn_s_setprio(0); } while (0)
#define PG8_WAIT_V(n) asm volatile("s_waitcnt vmcnt(" #n ")" ::: "memory")
#define PG8_WAIT_L(n) asm volatile("s_waitcnt lgkmcnt(" #n ")" ::: "memory")
#define PG8_BAR __builtin_amdgcn_s_barrier()
#define PG8_SCHED __builtin_amdgcn_sched_barrier(0)
    Unit cur, nxt; int ui = 0;
    if (!S.next(0, cur)) return;
    f32x4 acc[2][2][4][2];
#pragma unroll
    for (int a = 0; a < 2; ++a)
#pragma unroll
        for (int b = 0; b < 2; ++b)
#pragma unroll
            for (int m = 0; m < 4; ++m)
#pragma unroll
                for (int n = 0; n < 2; ++n) acc[a][b][m][n] = (f32x4){0.f, 0.f, 0.f, 0.f};
    bf16x8 At[4][2], B0[2][2], B1[2][2];
    const char* cA = (const char*)g.A + (size_t)cur.pm * tstep; const char* cB = (const char*)g.Bt + (size_t)cur.pn * tstep;
    S.a_ready(cur);
    if constexpr (SP2) {
        PG8_STAGE(PG8_SB(0, 0), cB, voffB); PG8_STAGE(PG8_SB(0, 1), cB + hstep, voffB); PG8_STAGE(PG8_SA(0, 0), cA, voffA); PG8_STAGE(PG8_SA(0, 1), cA + hstep, voffA);
        if (wr == 1) PG8_BAR;
        PG8_WAIT_V(2); PG8_BAR;
        PG8_STAGE(PG8_SB(1, 0), cB + kstep, voffB); PG8_STAGE(PG8_SA(1, 0), cA + kstep, voffA); PG8_STAGE(PG8_SB(1, 1), cB + hstep + kstep, voffB);
        PG8_WAIT_V(6); PG8_BAR;
    } else {
        PG8_STAGE(PG8_SB(0, 0), cB, voffB); PG8_STAGE(PG8_SA(0, 0), cA, voffA); PG8_STAGE(PG8_SB(0, 1), cB + hstep, voffB); PG8_STAGE(PG8_SA(0, 1), cA + hstep, voffA);
        if (wr == 1) PG8_BAR;
        PG8_WAIT_V(4); PG8_BAR;
        PG8_STAGE(PG8_SB(1, 0), cB + kstep, voffB); PG8_STAGE(PG8_SA(1, 0), cA + kstep, voffA); PG8_STAGE(PG8_SB(1, 1), cB + hstep + kstep, voffB);
        PG8_WAIT_V(6); PG8_BAR;
    }
    for (;;) {
        const bool has_next = S.next(ui + 1, nxt);
        const char* nA = has_next ? (const char*)g.A + (size_t)nxt.pm * tstep : cA; const char* nB = has_next ? (const char*)g.Bt + (size_t)nxt.pn * tstep : cB;
        for (int t = 0; t < nt; t += 2) {
            const bool last = (t == nt - 2);
            const char* a1 = cA + (size_t)(t + 1) * kstep;
            const char* a2 = last ? nA : cA + (size_t)(t + 2) * kstep; const char* b2 = last ? nB : cB + (size_t)(t + 2) * kstep;
            const char* a3 = a2 + kstep; const char* b3 = b2 + kstep;
            if (last && has_next) S.a_ready(nxt);
            if constexpr (SP2) {
            PG8_LDB(B0, 0, 0); PG8_LDB(B1, 0, 1); PG8_SCHED; PG8_LDA(At, 0, 0); PG8_STAGE(PG8_SA(1, 1), a1 + hstep, voffA);
            PG8_WAIT_V(8); PG8_WAIT_L(0); PG8_BAR; PG8_MMA(0, 0, At, B0); PG8_MMA(0, 1, At, B1); PG8_BAR; PG8_SCHED;
            PG8_LDA(At, 0, 1); PG8_STAGE(PG8_SB(0, 0), b2, voffB); PG8_STAGE(PG8_SB(0, 1), b2 + hstep, voffB); PG8_STAGE(PG8_SA(0, 0), a2, voffA);
            PG8_WAIT_V(8); PG8_WAIT_L(0); PG8_BAR; PG8_MMA(1, 0, At, B0); PG8_MMA(1, 1, At, B1); PG8_BAR; PG8_SCHED;
            PG8_LDB(B0, 1, 0); PG8_LDB(B1, 1, 1); PG8_SCHED; PG8_LDA(At, 1, 0); PG8_STAGE(PG8_SA(0, 1), a2 + hstep, voffA);
            PG8_WAIT_V(8); PG8_WAIT_L(0); PG8_BAR; PG8_MMA(0, 0, At, B0); PG8_MMA(0, 1, At, B1); PG8_BAR; PG8_SCHED;
            PG8_LDA(At, 1, 1); PG8_STAGE(PG8_SB(1, 0), b3, voffB); PG8_STAGE(PG8_SB(1, 1), b3 + hstep, voffB); PG8_STAGE(PG8_SA(1, 0), a3, voffA);
            PG8_WAIT_V(8); PG8_WAIT_L(0); PG8_BAR; PG8_MMA(1, 0, At, B0); PG8_MMA(1, 1, At, B1); PG8_BAR; PG8_SCHED;
            } else {
            PG8_LDB(B0, 0, 0); PG8_SCHED; PG8_LDA(At, 0, 0); PG8_STAGE(PG8_SA(1, 1), a1 + hstep, voffA);
            PG8_WAIT_L(8); PG8_BAR; PG8_WAIT_L(0); PG8_MMA(0, 0, At, B0); PG8_BAR; PG8_SCHED;
            PG8_LDB(B1, 0, 1); PG8_STAGE(PG8_SB(0, 0), b2, voffB);
            PG8_BAR; PG8_WAIT_L(0); PG8_MMA(0, 1, At, B1); PG8_BAR;
            PG8_LDA(At, 0, 1); PG8_STAGE(PG8_SA(0, 0), a2, voffA);
            PG8_BAR; PG8_WAIT_L(0); PG8_MMA(1, 0, At, B0); PG8_BAR; PG8_SCHED;
            PG8_STAGE(PG8_SB(0, 1), b2 + hstep, voffB);
            PG8_WAIT_V(6); PG8_BAR; PG8_MMA(1, 1, At, B1); PG8_BAR;
            PG8_LDB(B0, 1, 0); PG8_SCHED; PG8_LDA(At, 1, 0); PG8_STAGE(PG8_SA(0, 1), a2 + hstep, voffA);
            PG8_WAIT_L(8); PG8_BAR; PG8_WAIT_L(0); PG8_MMA(0, 0, At, B0); PG8_BAR; PG8_SCHED;
            PG8_LDB(B1, 1, 1); PG8_STAGE(PG8_SB(1, 0), b3, voffB);
            PG8_BAR; PG8_WAIT_L(0); PG8_MMA(0, 1, At, B1); PG8_BAR;
            PG8_LDA(At, 1, 1); PG8_STAGE(PG8_SA(1, 0), a3, voffA);
            PG8_BAR; PG8_WAIT_L(0); PG8_MMA(1, 0, At, B0); PG8_BAR; PG8_SCHED;
            PG8_STAGE(PG8_SB(1, 1), b3 + hstep, voffB);
            PG8_WAIT_V(6); PG8_BAR; PG8_MMA(1, 1, At, B1); PG8_BAR;
            }
        }
        if constexpr (ALIGN_EPI) { if (wr == 0) PG8_BAR; }
        if constexpr (!Epi::AFTER_DRAIN) { E(acc, cur, wr, wc, fr, fq); S.done(cur); }
        if (!has_next) break;
#pragma unroll
        for (int a = 0; a < 2; ++a)
#pragma unroll
            for (int b = 0; b < 2; ++b)
#pragma unroll
                for (int m = 0; m < 4; ++m)
#pragma unroll
                    for (int n = 0; n < 2; ++n) acc[a][b][m][n] = (f32x4){0.f, 0.f, 0.f, 0.f};
        cur = nxt; cA = nA; cB = nB; ++ui;
        if constexpr (ALIGN_EPI) { if (wr == 1) PG8_BAR; }
    }
    PG8_WAIT_V(0);
    if constexpr (!ALIGN_EPI) { if (wr == 0) PG8_BAR; }
    PG8_BAR;
    if constexpr (Epi::AFTER_DRAIN) { E.fused(acc, cur, wr, wc, fr, fq, lds, wid, lane); S.done(cur); }
#undef PG8_SA
#undef PG8_SB
#undef PG8_STAGE
#undef PG8_LDA
#undef PG8_LDB
#undef PG8_MMA
#undef PG8_WAIT_V
#undef PG8_WAIT_L
#undef PG8_BAR
#undef PG8_SCHED
}
}

#ifndef PG8_SP2
#define PG8_SP2 true
#endif
#ifndef PG8_ALIGN
#define PG8_ALIGN true
#endif

constexpr int NWAVES = 8;
constexpr int BATCH = 4, SEQ = 8192, DM = 1024, M = BATCH * SEQ;
constexpr int NPROJ = 3072, DFF = 2816, NGU = 2 * DFF;
constexpr int C_RQ = 0, C_RK = 256, C_RV = 512, C_RG = 1024, C_MQ = 1536, C_MK = 2048, C_MV = 2560;
constexpr int RH = 4, NCH = SEQ / 128;
constexpr int MH = 8, NBLK = SEQ / 256;
constexpr float EPS = 1e-6f;
constexpr float LOG2E = 1.4426950408889634f;
constexpr float QSCALE = 0.18033688011112042f;
__device__ __forceinline__ float ret_lg2(int h) { return h == 0 ? -0.04580368961312479f : h == 1 ? -0.018003552928331012f : h == 2 ? -0.007117849617096998f : -0.002820519062378663f; }

constexpr size_t MiB = 1u << 20;
constexpr size_t WS_CTL = 0, CTL_ZERO_BYTES = 1 * MiB;
constexpr size_t WS_WIN = 2 * MiB, WS_WOUT = 8 * MiB, WS_WGU = 10 * MiB, WS_WDN = 21 * MiB + 512 * 1024, WS_ROPE = 27 * MiB, WS_KMEAN = 29 * MiB;
constexpr size_t WS_H = 32 * MiB;
constexpr size_t WS_PROJ = 96 * MiB;
constexpr size_t WS_SST = 288 * MiB;
constexpr size_t WS_PST = 320 * MiB;
constexpr size_t WS_LIST = 336 * MiB;
constexpr size_t WS_PO = 352 * MiB;
constexpr size_t WS_PML = 448 * MiB;
constexpr size_t WS_END = 456 * MiB;
constexpr int CW_BAR = 4096;
constexpr int CW_LCNT = 16384;
constexpr int CW_QHEAD = 20480;
static_assert((CW_QHEAD + 64) * 4 <= (int)CTL_ZERO_BYTES, "ctl");

constexpr int RING_OFF = 0, RING_BYTES = 131072;
constexpr int LDSCTL_OFF = RING_BYTES, MISC_OFF = LDSCTL_OFF + 320;
constexpr int BIAS_OFF = MISC_OFF + 128;
constexpr int LDS_BYTES = 147456;
static_assert(BIAS_OFF + 4096 <= LDS_BYTES, "LDS map");

#define GAS __attribute__((address_space(1)))
#define LAS __attribute__((address_space(3)))
typedef unsigned short bf16;
typedef unsigned v4u __attribute__((ext_vector_type(4)));
typedef unsigned v2u __attribute__((ext_vector_type(2)));
typedef float f32x4 __attribute__((ext_vector_type(4)));
typedef float f32x16 __attribute__((ext_vector_type(16)));
typedef short s16x4 __attribute__((ext_vector_type(4)));
typedef short bf16x8 __attribute__((ext_vector_type(8)));
typedef GAS unsigned gu32;
typedef GAS unsigned long long gu64;
#define RLX_AGENT __ATOMIC_RELAXED, __HIP_MEMORY_SCOPE_AGENT
#define LDS_WAIT() asm volatile("s_waitcnt lgkmcnt(0)" ::: "memory")
#define VM_WAIT() asm volatile("s_waitcnt vmcnt(0)" ::: "memory")
__device__ __forceinline__ unsigned long long rt() { return __builtin_amdgcn_s_memrealtime(); }
__device__ __forceinline__ unsigned f2bf(float f) { unsigned u = __builtin_bit_cast(unsigned, f); return (u + 0x7fffu + ((u >> 16) & 1u)) >> 16; }
__device__ __forceinline__ unsigned pk2(float lo, float hi) { return f2bf(lo) | (f2bf(hi) << 16); }

#define XB_TMO      128
#define XB_XCNT(j)  (256  + 64 * (j))
#define XB_XSUB(j)  (1280 + 64 * (j))
#define XB_XGEN(j)  (2304 + 64 * (j))
#define XB_TOP      3328
#define XB_TOPGEN   3392
#define XCD_BAR_WORDS 3456
#define XB_SPIN_CAP (1u << 18)

__device__ __forceinline__ unsigned xb_ld(unsigned* p)              { return __hip_atomic_load(p, __ATOMIC_RELAXED, __HIP_MEMORY_SCOPE_AGENT); }
__device__ __forceinline__ unsigned xb_add(unsigned* p, unsigned v) { return __hip_atomic_fetch_add(p, v, __ATOMIC_RELAXED, __HIP_MEMORY_SCOPE_AGENT); }
__device__ __forceinline__ unsigned xb_xcc_id() { return (unsigned)__builtin_amdgcn_s_getreg((3 << 11) | 20) & 0xFu; }
#define XB_SPIN(cond, bar) do { unsigned _sp = 0; while (cond) { __builtin_amdgcn_s_sleep(1); \
    if ((++_sp & 255u) == 0u) { if (xb_ld(&(bar)[XB_TMO])) break; if (_sp > XB_SPIN_CAP) { atomicAdd(&(bar)[XB_TMO], 1u); break; } } } } while (0)

struct XcdBarrier {
    unsigned* bar; unsigned x;
    volatile LAS unsigned* st;
};

__device__ __forceinline__ XcdBarrier xcd_barrier_post(unsigned* bar, volatile LAS unsigned* st) {
    XcdBarrier b; b.bar = bar; b.x = xb_xcc_id(); b.st = st;
    if (threadIdx.x == 0) (void)xb_add(&bar[XB_XCNT(b.x)], 1u);
    return b;
}
__device__ __forceinline__ void xcd_barrier_complete(unsigned* bar, unsigned x, unsigned& nloc, unsigned& nx) {
    const unsigned G = gridDim.x * gridDim.y * gridDim.z;
    unsigned sum, cnt, mine, sp = 0u;
    for (;;) {
        sum = 0u; cnt = 0u; mine = 0u;
#pragma unroll
        for (unsigned j = 0; j < 16; ++j) { const unsigned c = xb_ld(&bar[XB_XCNT(j)]); sum += c; cnt += (c > 0u) ? 1u : 0u; mine = (j == x) ? c : mine; }
        if (sum == G) break;
        __builtin_amdgcn_s_sleep(1);
        if ((++sp & 255u) == 0u) { if (xb_ld(&bar[XB_TMO])) break; if (sp > XB_SPIN_CAP) { atomicAdd(&bar[XB_TMO], 1u); break; } }
    }
    nloc = mine > 0u ? mine : 1u; nx = cnt > 0u ? cnt : 1u;
}

__device__ __forceinline__ void xcd_barrier(const XcdBarrier& b) {
    asm volatile("s_waitcnt vmcnt(0)" ::: "memory");
    __syncthreads();
    if (threadIdx.x == 0) {
        unsigned* bar = b.bar;
        __builtin_amdgcn_s_waitcnt(0);
        unsigned nloc = b.st[0], nx = b.st[1];
        if (nloc == 0u) { xcd_barrier_complete(bar, b.x, nloc, nx); b.st[0] = nloc; b.st[1] = nx; }
        const unsigned old = xb_add(&bar[XB_XSUB(b.x)], 1u);
        const unsigned gen = old / nloc;
        if (old + 1u == (gen + 1u) * nloc) {
            __builtin_amdgcn_fence(__ATOMIC_RELEASE, "agent");
            asm volatile("s_waitcnt vmcnt(0)" ::: "memory");
            const unsigned og = xb_add(&bar[XB_TOP], 1u);
            const unsigned tg = og / nx;
            if (og + 1u == (tg + 1u) * nx) xb_add(&bar[XB_TOPGEN], 1u);
            else XB_SPIN(xb_ld(&bar[XB_TOPGEN]) == tg, bar);
            __builtin_amdgcn_fence(__ATOMIC_ACQUIRE, "agent");
            xb_add(&bar[XB_XGEN(b.x)], 1u);
            asm volatile("s_waitcnt vmcnt(0)" ::: "memory");
        } else {
            XB_SPIN(xb_ld(&bar[XB_XGEN(b.x)]) == gen, bar);
            __builtin_amdgcn_fence(__ATOMIC_ACQUIRE, "agent");
            asm volatile("s_waitcnt vmcnt(0)" ::: "memory");
        }
    }
    __syncthreads();
}


struct Frame {
    LAS unsigned char* lds;
    volatile LAS unsigned* MISC;
    gu32* ctl;
    int tid, lane, wave;
    int vcu, G;
    const float *x, *w_in, *w_out, *g_pre_mix, *g_post_mix, *g_pre_ffn, *g_post_ffn, *rel_bias, *w_gate, *w_up, *w_down;
    float* out;
    bf16 *Win_t, *Wout_t, *Wgu_t, *Wdn_t;
    float *rope, *kmean, *sst, *pml;
    bf16 *H, *PROJ, *PST, *PO;
    unsigned short* list;
};
__device__ __forceinline__ float wave_sum(float v) {
#pragma unroll
    for (int o = 1; o < 64; o <<= 1) v += __shfl_xor(v, o);
    return v;
}
__device__ __forceinline__ float half_max(float v) { auto rr = __builtin_amdgcn_permlane32_swap(__float_as_uint(v), __float_as_uint(v), false, false); const unsigned a = rr[0], b = rr[1]; return fmaxf(__uint_as_float(a), __uint_as_float(b)); }
__device__ __forceinline__ float half_sum(float v) { auto rr = __builtin_amdgcn_permlane32_swap(__float_as_uint(v), __float_as_uint(v), false, false); const unsigned a = rr[0], b = rr[1]; return __uint_as_float(a) + __uint_as_float(b); }
__device__ __forceinline__ float bf_lo(unsigned w) { return __builtin_bit_cast(float, w << 16); }
__device__ __forceinline__ float bf_hi(unsigned w) { return __builtin_bit_cast(float, w & 0xffff0000u); }
__device__ __forceinline__ int crow(int r, int hi) { return (r & 3) + 8 * (r >> 2) + 4 * hi; }
#define MFMA32(a, b, c) __builtin_amdgcn_mfma_f32_32x32x16_bf16((a), (b), (c), 0, 0, 0)
typedef short v4i16_t __attribute__((ext_vector_type(4)));
__device__ __forceinline__ s16x4 tr_read(const LAS unsigned char* p) { return __builtin_bit_cast(s16x4, __builtin_amdgcn_ds_read_tr16_b64_v4i16((LAS v4i16_t*)p)); }
__device__ __forceinline__ bf16x8 tr_frag(const LAS unsigned char* p, int hi_off) {
    const s16x4 lo = tr_read(p), hi = tr_read(p + hi_off);
    return (bf16x8){lo[0], lo[1], lo[2], lo[3], hi[0], hi[1], hi[2], hi[3]};
}
__device__ __forceinline__ bf16x8 pack8(const f32x16& p, int s) {
    v4u w; w.x = pk2(p[8 * s], p[8 * s + 1]); w.y = pk2(p[8 * s + 2], p[8 * s + 3]); w.z = pk2(p[8 * s + 4], p[8 * s + 5]); w.w = pk2(p[8 * s + 6], p[8 * s + 7]);
    return __builtin_bit_cast(bf16x8, w);
}
__device__ __forceinline__ int t5_bucket(int n) {
    if (n < 16) return n;
    int b = 15;
    const int T[16] = {16, 19, 21, 24, 27, 31, 35, 40, 46, 52, 59, 67, 77, 87, 99, 113};
#pragma unroll
    for (int i = 0; i < 16; ++i) b += (n >= T[i]) ? 1 : 0;
    return b;
}

struct ColSrc { const float* p; float s; };
template <int MAT> __device__ __forceinline__ ColSrc colsrc(const Frame& F, int n) {
    ColSrc c; c.s = 1.f;
    if (MAT == 0) {
        int col = n;
        if (n < 512) { const int hd = n >> 6, g = (n >> 3) & 7, t = n & 7; col = 64 * hd + ((t < 4) ? (4 * g + t) : (32 + 4 * g + (t - 4))); }
        if (n >= C_RK && n < C_RV) c.s = 0.125f;
        if (n >= C_MQ && n < C_MK) c.s = QSCALE;
        c.p = F.w_in + col;
    } else if (MAT == 1) { c.p = F.w_out + n; }
    else if (MAT == 2) { const int g = n >> 3, t = n & 7; c.p = (t < 4) ? (F.w_gate + 4 * g + t) : (F.w_up + 4 * g + (t - 4)); }
    else { c.p = F.w_down + n; }
    return c;
}
template <int MAT> __device__ __forceinline__ void p0_transpose_item(const Frame& F, int K, int ldw, bf16* WT, int nblk, LAS float* scr, int item, int lane) {
    const int kb = item / nblk, nb = item % nblk, k0 = 64 * kb, n0 = 32 * nb;
    const ColSrc cs = colsrc<MAT>(F, n0 + (lane & 31));
#pragma unroll 8
    for (int i = 0; i < 32; ++i) { const int kk = 2 * i + (lane >> 5); scr[kk * 33 + (lane & 31)] = cs.p[(size_t)(k0 + kk) * ldw] * cs.s; }
    LDS_WAIT(); asm volatile("" ::: "memory");
    const int c = lane & 7;
#pragma unroll
    for (int j = 0; j < 4; ++j) { const int n = (lane >> 3) + 8 * j; const LAS float* s = scr + (8 * c) * 33 + n;
        v4u o; o.x = pk2(s[0 * 33], s[1 * 33]); o.y = pk2(s[2 * 33], s[3 * 33]); o.z = pk2(s[4 * 33], s[5 * 33]); o.w = pk2(s[6 * 33], s[7 * 33]);
        *(GAS v4u*)(WT + (size_t)(n0 + n) * K + k0 + 8 * c) = o; }
    LDS_WAIT(); asm volatile("" ::: "memory");
}
__device__ __forceinline__ void rms_row_to_bf16(const Frame& F, const float* xrow, const float* g, bf16* orow) {
    const GAS f32x4* xr = (const GAS f32x4*)xrow + F.lane; const GAS f32x4* gr = (const GAS f32x4*)g + F.lane;
    f32x4 v[4]; float s = 0.f;
#pragma unroll
    for (int j = 0; j < 4; ++j) { v[j] = xr[64 * j]; s += (v[j].x * v[j].x + v[j].y * v[j].y) + (v[j].z * v[j].z + v[j].w * v[j].w); }
    const float rstd = 1.f / sqrtf(wave_sum(s) * (1.f / DM) + EPS);
    GAS unsigned long long* o8 = (GAS unsigned long long*)orow + F.lane;
#pragma unroll
    for (int j = 0; j < 4; ++j) { const f32x4 gg = gr[64 * j]; o8[64 * j] = (unsigned long long)pk2(v[j].x * rstd * gg.x, v[j].y * rstd * gg.y) | ((unsigned long long)pk2(v[j].z * rstd * gg.z, v[j].w * rstd * gg.w) << 32); }
}
__device__ __forceinline__ void p0_prologue(Frame& F) {
    LAS float* scr = (LAS float*)(F.lds + RING_OFF + F.wave * 16384);
    const int gw = F.vcu * NWAVES + F.wave, NGW = F.G * NWAVES;
    constexpr int I_IN = (DM / 64) * (NPROJ / 32), I_OUT = (DM / 64) * (DM / 32), I_GU = (DM / 64) * (NGU / 32), I_DN = (DFF / 64) * (DM / 32);
    constexpr int NITEMS = I_IN + I_OUT + I_GU + I_DN;
    for (int it = gw; it < NITEMS; it += NGW) {
        int r = it;
        if (r < I_IN) { p0_transpose_item<0>(F, DM, NPROJ, F.Win_t, NPROJ / 32, scr, r, F.lane); continue; } r -= I_IN;
        if (r < I_OUT) { p0_transpose_item<1>(F, DM, DM, F.Wout_t, DM / 32, scr, r, F.lane); continue; } r -= I_OUT;
        if (r < I_GU) { p0_transpose_item<2>(F, DM, DFF, F.Wgu_t, NGU / 32, scr, r, F.lane); continue; } r -= I_GU;
        p0_transpose_item<3>(F, DFF, DM, F.Wdn_t, DM / 32, scr, r, F.lane);
    }
    for (int e = (F.vcu * NWAVES * 64) + F.tid; e < SEQ * 32; e += F.G * NWAVES * 64) {
        const int pos = e >> 5, j = e & 31;
        const float inv_freq = (float)exp2(-(double)j * (13.287712379549449 / 32.0));
        const float ang = (float)pos * inv_freq;
        double t = (double)ang * 0.15915494309189535; t -= floor(t);
        const float tf = (float)t;
        F.rope[(size_t)pos * 64 + j] = __builtin_amdgcn_cosf(tf);
        F.rope[(size_t)pos * 64 + 32 + j] = __builtin_amdgcn_sinf(tf);
    }
    for (int m = gw; m < M; m += NGW) rms_row_to_bf16(F, F.x + (size_t)m * DM, F.g_pre_mix, F.H + (size_t)m * DM);
}

__device__ __forceinline__ int kr_off(int r, int ch) { return r * 128 + ((ch ^ ((r >> 1) & 7)) << 4); }
template <int NCB> __device__ __forceinline__ int tr_off(int r, int ch) { return ((r >> 3) * NCB + (ch >> 2)) * 512 + (r & 7) * 64 + (ch & 3) * 16; }

__device__ __forceinline__ void stage_kv256(const Frame& F, const bf16* Kg, const bf16* Vg, int ld, LAS unsigned char* kimg, LAS unsigned char* vimg) {
#pragma unroll
    for (int i = 0; i < 4; ++i) { const int c = F.tid + 512 * i, r = c >> 3, ch = c & 7;
        const v4u kv = *(const GAS v4u*)(Kg + (size_t)r * ld + 8 * ch); const v4u vv = *(const GAS v4u*)(Vg + (size_t)r * ld + 8 * ch);
        *(LAS v4u*)(kimg + kr_off(r, ch)) = kv; *(LAS v4u*)(vimg + tr_off<2>(r, ch)) = vv; }
}
template <int BIASMODE> __device__ __forceinline__ void attend(const LAS unsigned char* kimg, const LAS unsigned char* vimg, const bf16x8 (&qf)[4], int kb0, int kb1,
                                                                int qpos, int kpos0, float cb, const LAS float* tbl, int r32, int hh, int lane, float& m, float& l, f32x16 (&O)[2]) {
    const int blk = (lane >> 4) & 1, q4 = (lane & 15) >> 2, p4 = lane & 3;
    for (int kb = kb0; kb < kb1; ++kb) {
        f32x16 S = {};
#pragma unroll
        for (int d0 = 0; d0 < 4; ++d0) { const bf16x8 kf = *(const LAS bf16x8*)(kimg + kr_off(32 * kb + r32, 2 * d0 + hh)); S = MFMA32(kf, qf[d0], S); }
        float mx = -3.0e38f;
#pragma unroll
        for (int x = 0; x < 16; ++x) {
            if (BIASMODE == 0) S[x] += cb;
            else { const int rel = qpos - (kpos0 + 32 * kb + crow(x, hh)); const int ri = rel < 0 ? 0 : (rel > 127 ? 127 : rel); S[x] += tbl[ri]; if (BIASMODE == 2 && rel < 0) S[x] = -INFINITY; }
            mx = fmaxf(mx, S[x]);
        }
        mx = half_max(mx);
        const float mn = fmaxf(m, mx), alpha = __builtin_amdgcn_exp2f(m - mn);
        float rs = 0.f;
#pragma unroll
        for (int x = 0; x < 16; ++x) { S[x] = __builtin_amdgcn_exp2f(S[x] - mn); rs += S[x]; }
        rs = half_sum(rs);
        l = l * alpha + rs; m = mn;
#pragma unroll
        for (int x = 0; x < 16; ++x) { O[0][x] *= alpha; O[1][x] *= alpha; }
#pragma unroll
        for (int s = 0; s < 2; ++s) { const bf16x8 pf = pack8(S, s);
#pragma unroll
            for (int db = 0; db < 2; ++db) { const bf16x8 vf = tr_frag(vimg + ((4 * kb + 2 * s) * 2 + db) * 512 + (4 * hh + q4) * 64 + blk * 32 + p4 * 8, 1024); O[db] = MFMA32(vf, pf, O[db]); } }
    }
}

__device__ __forceinline__ void p2_ret_state_unit(Frame& F, int u) {
    const int i = u & 63, bh = u >> 6, h = bh & 3, b = bh >> 2;
    LAS unsigned char* kimg = F.lds + RING_OFF; LAS unsigned char* vimg = F.lds + RING_OFF + 16384;
    const bf16* base = F.PROJ + (size_t)(b * SEQ + i * 128) * NPROJ;
    const float lg2 = ret_lg2(h);
#pragma unroll
    for (int k = 0; k < 2; ++k) { const int c = F.tid + 512 * k, j = c >> 3, ch = c & 7;
        const v4u kv = *(const GAS v4u*)(base + (size_t)j * NPROJ + C_RK + 64 * h + 8 * ch);
        const float dec = __builtin_amdgcn_exp2f((float)(127 - j) * lg2);
        v4u o; o.x = pk2(bf_lo(kv.x) * dec, bf_hi(kv.x) * dec); o.y = pk2(bf_lo(kv.y) * dec, bf_hi(kv.y) * dec); o.z = pk2(bf_lo(kv.z) * dec, bf_hi(kv.z) * dec); o.w = pk2(bf_lo(kv.w) * dec, bf_hi(kv.w) * dec);
        *(LAS v4u*)(kimg + tr_off<2>(j, ch)) = o; }
#pragma unroll
    for (int k = 0; k < 4; ++k) { const int c = F.tid + 512 * k, j = c >> 4, ch = c & 15;
        const v4u vv = *(const GAS v4u*)(base + (size_t)j * NPROJ + C_RV + 128 * h + 8 * ch);
        *(LAS v4u*)(vimg + tr_off<4>(j, ch)) = vv; }
    __syncthreads();
    const int lane = F.lane, r32 = lane & 31, hh = lane >> 5, blk = (lane >> 4) & 1, q4 = (lane & 15) >> 2, p4 = lane & 3;
    const int eb = F.wave >> 1, db = F.wave & 1;
    f32x16 acc = {};
#pragma unroll
    for (int s = 0; s < 8; ++s) {
        const bf16x8 a = tr_frag(vimg + ((2 * s + hh) * 4 + eb) * 512 + q4 * 64 + blk * 32 + p4 * 8, 256);
        const bf16x8 bq = tr_frag(kimg + ((2 * s + hh) * 2 + db) * 512 + q4 * 64 + blk * 32 + p4 * 8, 256);
        acc = MFMA32(a, bq, acc);
    }
    float* so = F.sst + (size_t)u * 8192;
#pragma unroll
    for (int x = 0; x < 16; ++x) so[(32 * eb + crow(x, hh)) * 64 + 32 * db + r32] = acc[x];
    __syncthreads();
}
__device__ __forceinline__ void p2_kmean_unit(Frame& F, int u) {
    const int n = u & 31, bhm = u >> 5, hm = bhm & 7, b = bhm >> 3;
    LAS float* red = (LAS float*)(F.lds + RING_OFF);
    const bf16* base = F.PROJ + (size_t)(b * SEQ + n * 256) * NPROJ + C_MK + 64 * hm;
    const int ch = F.tid & 7, rg = F.tid >> 3;
    float s[8] = {0.f, 0.f, 0.f, 0.f, 0.f, 0.f, 0.f, 0.f};
#pragma unroll
    for (int k = 0; k < 4; ++k) { const v4u kv = *(const GAS v4u*)(base + (size_t)(rg + 64 * k) * NPROJ + 8 * ch);
        s[0] += bf_lo(kv.x); s[1] += bf_hi(kv.x); s[2] += bf_lo(kv.y); s[3] += bf_hi(kv.y); s[4] += bf_lo(kv.z); s[5] += bf_hi(kv.z); s[6] += bf_lo(kv.w); s[7] += bf_hi(kv.w); }
#pragma unroll
    for (int k = 0; k < 8; ++k) red[rg * 64 + 8 * ch + k] = s[k];
    __syncthreads();
    if (F.tid < 64) { float t = 0.f; for (int g = 0; g < 64; ++g) t += red[g * 64 + F.tid]; F.kmean[(size_t)u * 64 + F.tid] = t * (1.f / 256.f); }
    __syncthreads();
}

__device__ __forceinline__ void p3_scan(Frame& F) {
    for (int g = F.vcu * 512 + F.tid; g < 16 * 8192; g += F.G * 512) {
        const int bh = g >> 13, ed = g & 8191, h = bh & 3;
        const float cd = __builtin_amdgcn_exp2f(128.f * ret_lg2(h));
        const float* sp = F.sst + (size_t)bh * 64 * 8192 + ed; bf16* pp = F.PST + (size_t)bh * 64 * 8192 + ed;
        float st = 0.f;
        for (int i0 = 0; i0 < 64; i0 += 8) {
            float sv[8];
#pragma unroll
            for (int k = 0; k < 8; ++k) sv[k] = sp[(size_t)(i0 + k) * 8192];
#pragma unroll
            for (int k = 0; k < 8; ++k) { pp[(size_t)(i0 + k) * 8192] = (bf16)f2bf(st); st = st * cd + sv[k]; }
        }
    }
}
__device__ __forceinline__ void top3_insert(float v, int n, float (&tv)[3], int (&ti)[3]) {
    const bool b0 = (v > tv[0]) || (v == tv[0] && n < ti[0]);
    const bool b1 = (v > tv[1]) || (v == tv[1] && n < ti[1]);
    const bool b2 = (v > tv[2]) || (v == tv[2] && n < ti[2]);
    if (b0) { tv[2] = tv[1]; ti[2] = ti[1]; tv[1] = tv[0]; ti[1] = ti[0]; tv[0] = v; ti[0] = n; }
    else if (b1) { tv[2] = tv[1]; ti[2] = ti[1]; tv[1] = v; ti[1] = n; }
    else if (b2) { tv[2] = v; ti[2] = n; }
}
__device__ __forceinline__ void p3_topk_unit(Frame& F, int u) {
    const int qb = u & 31, bhm = u >> 5, hm = bhm & 7, b = bhm >> 3;
    LAS float* km = (LAS float*)(F.lds + RING_OFF);
    LAS float* mv = (LAS float*)(F.lds + RING_OFF + 8192);
    LAS int* mi = (LAS int*)(F.lds + RING_OFF + 8192 + 3072);
    LAS unsigned* cnt = (LAS unsigned*)(F.lds + RING_OFF + 16384);
    LAS unsigned* gbase = (LAS unsigned*)(F.lds + RING_OFF + 16384 + 128);
    LAS unsigned short* stg = (LAS unsigned short*)(F.lds + RING_OFF + 20480);
    for (int k = F.tid; k < qb * 64; k += 512) km[k] = F.kmean[(size_t)(bhm * 32) * 64 + k];
    if (F.tid < 32) cnt[F.tid] = 0u;
    const int ql = F.tid & 255, half = F.tid >> 8;
    const bf16* qp = F.PROJ + (size_t)(b * SEQ + qb * 256 + ql) * NPROJ + C_MQ + 64 * hm;
    float q[64];
#pragma unroll
    for (int c = 0; c < 8; ++c) { const v4u w = *(const GAS v4u*)(qp + 8 * c);
        q[8 * c] = bf_lo(w.x); q[8 * c + 1] = bf_hi(w.x); q[8 * c + 2] = bf_lo(w.y); q[8 * c + 3] = bf_hi(w.y); q[8 * c + 4] = bf_lo(w.z); q[8 * c + 5] = bf_hi(w.z); q[8 * c + 6] = bf_lo(w.w); q[8 * c + 7] = bf_hi(w.w); }
    __syncthreads();
    float tv[3] = {-INFINITY, -INFINITY, -INFINITY}; int ti[3] = {64, 65, 66};
    for (int n = half; n < qb; n += 2) {
        const LAS f32x4* kr = (const LAS f32x4*)(km + n * 64);
        float g0 = 0.f, g1 = 0.f;
#pragma unroll
        for (int c = 0; c < 16; c += 2) { const f32x4 k0 = kr[c], k1 = kr[c + 1];
            g0 += q[4 * c] * k0.x + q[4 * c + 1] * k0.y + q[4 * c + 2] * k0.z + q[4 * c + 3] * k0.w;
            g1 += q[4 * c + 4] * k1.x + q[4 * c + 5] * k1.y + q[4 * c + 6] * k1.z + q[4 * c + 7] * k1.w; }
        top3_insert(g0 + g1, n, tv, ti);
    }
    if (half == 1) {
#pragma unroll
        for (int k = 0; k < 3; ++k) { mv[ql * 3 + k] = tv[k]; mi[ql * 3 + k] = ti[k]; } }
    __syncthreads();
    if (half == 0) {
#pragma unroll
        for (int k = 0; k < 3; ++k) { const float v = mv[ql * 3 + k]; const int n = mi[ql * 3 + k]; if (n < 32) top3_insert(v, n, tv, ti); }
#pragma unroll
        for (int k = 0; k < 3; ++k) if (ti[k] < 32) { const unsigned p = atomicAdd((unsigned*)(cnt + ti[k]), 1u); stg[ti[k] * 256 + p] = (unsigned short)((qb * 256 + ql) | (k << 13)); }
    }
    __syncthreads();
    if (F.tid < qb) gbase[F.tid] = __hip_atomic_fetch_add(F.ctl + CW_LCNT + bhm * 32 + F.tid, cnt[F.tid], RLX_AGENT);
    __syncthreads();
    for (int n = 0; n < qb; ++n) { const unsigned c = cnt[n], gb = gbase[n]; unsigned short* dst = F.list + (size_t)(bhm * 32 + n) * 8192 + gb;
        for (unsigned k = F.tid; k < c; k += 512) dst[k] = stg[n * 256 + k]; }
    __syncthreads();
}

__device__ __forceinline__ void p4_ret_out_unit(Frame& F, int u) {
    const int ip = u & 31, bh = u >> 5, h = bh & 3, b = bh >> 2;
    const int c01 = F.wave >> 2, qbk = F.wave & 3, i = 2 * ip + c01;
    LAS unsigned char* kimg0 = F.lds + RING_OFF; LAS unsigned char* vimg0 = F.lds + RING_OFF + 32768;
    const bf16* base = F.PROJ + (size_t)(b * SEQ + ip * 256) * NPROJ;
#pragma unroll
    for (int k = 0; k < 4; ++k) { const int c = F.tid + 512 * k, j = c >> 3, ch = c & 7;
        const v4u kv = *(const GAS v4u*)(base + (size_t)j * NPROJ + C_RK + 64 * h + 8 * ch);
        *(LAS v4u*)(kimg0 + (j >> 7) * 16384 + kr_off(j & 127, ch)) = kv; }
#pragma unroll
    for (int k = 0; k < 8; ++k) { const int c = F.tid + 512 * k, j = c >> 4, ch = c & 15;
        const v4u vv = *(const GAS v4u*)(base + (size_t)j * NPROJ + C_RV + 128 * h + 8 * ch);
        *(LAS v4u*)(vimg0 + (j >> 7) * 32768 + tr_off<4>(j & 127, ch)) = vv; }
    __syncthreads();
    const LAS unsigned char* kimg = kimg0 + c01 * 16384; const LAS unsigned char* vimg = vimg0 + c01 * 32768;
    const int lane = F.lane, r32 = lane & 31, hh = lane >> 5, blk = (lane >> 4) & 1, q4 = (lane & 15) >> 2, p4 = lane & 3;
    const float lg2 = ret_lg2(h);
    const int iq = 32 * qbk + r32;
    const size_t tok = (size_t)b * SEQ + i * 128 + iq;
    const bf16* qp = F.PROJ + tok * NPROJ + C_RQ + 64 * h;
    bf16x8 qf[4];
#pragma unroll
    for (int d0 = 0; d0 < 4; ++d0) qf[d0] = *(const GAS bf16x8*)(qp + 16 * d0 + 8 * hh);
    f32x16 acc[4];
    const bf16* pst = F.PST + (size_t)(bh * 64 + i) * 8192;
#pragma unroll
    for (int eb = 0; eb < 4; ++eb) { acc[eb] = (f32x16){};
#pragma unroll
        for (int d0 = 0; d0 < 4; ++d0) { const bf16x8 sf = *(const GAS bf16x8*)(pst + (size_t)(32 * eb + r32) * 64 + 16 * d0 + 8 * hh); acc[eb] = MFMA32(sf, qf[d0], acc[eb]); } }
    const float qdec = __builtin_amdgcn_exp2f((float)(iq + 1) * lg2);
#pragma unroll
    for (int eb = 0; eb < 4; ++eb)
#pragma unroll
        for (int x = 0; x < 16; ++x) acc[eb][x] *= qdec;
    for (int kb = 0; kb <= qbk; ++kb) {
        f32x16 S = {};
#pragma unroll
        for (int d0 = 0; d0 < 4; ++d0) { const bf16x8 kf = *(const LAS bf16x8*)(kimg + kr_off(32 * kb + r32, 2 * d0 + hh)); S = MFMA32(kf, qf[d0], S); }
#pragma unroll
        for (int x = 0; x < 16; ++x) { const int diff = iq - (32 * kb + crow(x, hh)); const float dec = __builtin_amdgcn_exp2f((float)diff * lg2); S[x] = diff >= 0 ? S[x] * dec : 0.f; }
#pragma unroll
        for (int s = 0; s < 2; ++s) { const bf16x8 pf = pack8(S, s);
#pragma unroll
            for (int eb = 0; eb < 4; ++eb) { const bf16x8 vf = tr_frag(vimg + ((4 * kb + 2 * s) * 4 + eb) * 512 + (4 * hh + q4) * 64 + blk * 32 + p4 * 8, 2048); acc[eb] = MFMA32(vf, pf, acc[eb]); } }
    }
    float ss = 0.f;
#pragma unroll
    for (int eb = 0; eb < 4; ++eb)
#pragma unroll
        for (int x = 0; x < 16; ++x) ss += acc[eb][x] * acc[eb][x];
    ss = half_sum(ss);
    const float rstd = 1.f / sqrtf(ss * (1.f / 128.f) + EPS);
    const bf16* gp = F.PROJ + tok * NPROJ + C_RG + 128 * h; bf16* op = F.H + tok * DM + 128 * h;
#pragma unroll
    for (int eb = 0; eb < 4; ++eb)
#pragma unroll
        for (int xg = 0; xg < 4; ++xg) { const int e = 32 * eb + 8 * xg + 4 * hh;
            const v2u gw = *(const GAS v2u*)(gp + e); float gv[4] = {bf_lo(gw.x), bf_hi(gw.x), bf_lo(gw.y), bf_hi(gw.y)}; float o[4];
#pragma unroll
            for (int k = 0; k < 4; ++k) { const float sg = gv[k] * __builtin_amdgcn_rcpf(1.f + __builtin_amdgcn_exp2f(-gv[k] * LOG2E)); o[k] = acc[eb][4 * xg + k] * rstd * sg; }
            v2u w; w.x = pk2(o[0], o[1]); w.y = pk2(o[2], o[3]); *(GAS v2u*)(op + e) = w; }
    __syncthreads();
}
__device__ __forceinline__ void build_bias_table(Frame& F) {
    LAS float* tbl = (LAS float*)(F.lds + BIAS_OFF);
    for (int k = F.tid; k < 8 * 128; k += 512) { const int hm = k >> 7, rel = k & 127; tbl[k] = F.rel_bias[t5_bucket(rel) * MH + hm] * LOG2E; }
}
__device__ __forceinline__ void p4_moba_sel(Frame& F) {
    LAS unsigned* pre = (LAS unsigned*)(F.lds + RING_OFF + 65536);
    LAS unsigned* wsum = (LAS unsigned*)(F.lds + RING_OFF + 65536 + 4096);
    LAS unsigned* cur = (LAS unsigned*)(F.lds + RING_OFF + 65536 + 4096 + 64);
    LAS unsigned char* kimg = F.lds + RING_OFF; LAS unsigned char* vimg = F.lds + RING_OFF + 32768;
    const LAS float* tbl = (const LAS float*)(F.lds + BIAS_OFF);
    {
        const unsigned c0 = __hip_atomic_load(F.ctl + CW_LCNT + 2 * F.tid, RLX_AGENT), c1 = __hip_atomic_load(F.ctl + CW_LCNT + 2 * F.tid + 1, RLX_AGENT);
        const unsigned i0 = (c0 + 255u) >> 8, i1 = (c1 + 255u) >> 8; unsigned s = i0 + i1;
#pragma unroll
        for (int o = 1; o < 64; o <<= 1) { const unsigned t = __shfl_up(s, o); if (F.lane >= o) s += t; }
        if (F.lane == 63) wsum[F.wave] = s;
        __syncthreads();
        unsigned off = 0; for (int w = 0; w < F.wave; ++w) off += wsum[w];
        pre[2 * F.tid] = off + s - i1; pre[2 * F.tid + 1] = off + s;
        __syncthreads();
    }
    const unsigned total = pre[1023];
    const int lane = F.lane, r32 = lane & 31, hh = lane >> 5;
    for (;;) {
        if (F.tid == 0) cur[0] = __hip_atomic_fetch_add(F.ctl + CW_QHEAD, 1u, RLX_AGENT);
        __syncthreads();
        const unsigned it = cur[0];
        if (it >= total) break;
        int lo = 0, hi = 1023;
        while (lo < hi) { const int mid = (lo + hi) >> 1; if (pre[mid] > it) hi = mid; else lo = mid + 1; }
        const int L = lo, n = L & 31, bhm = L >> 5, hm = bhm & 7, b = bhm >> 3;
        const unsigned k = it - (L ? pre[L - 1] : 0u);
        const unsigned cntL = __hip_atomic_load(F.ctl + CW_LCNT + L, RLX_AGENT);
        const bf16* kvb = F.PROJ + (size_t)(b * SEQ + n * 256) * NPROJ + 64 * hm;
        stage_kv256(F, kvb + C_MK, kvb + C_MV, NPROJ, kimg, vimg);
        __syncthreads();
        const unsigned e0 = k * 256u + 32u * F.wave;
        if (e0 < cntL) {
            const unsigned ei = e0 + r32; const bool valid = ei < cntL;
            const unsigned ent = F.list[(size_t)L * 8192 + (valid ? ei : cntL - 1u)];
            const int pos = ent & 8191, slot = ent >> 13;
            const bf16* qp = F.PROJ + (size_t)(b * SEQ + pos) * NPROJ + C_MQ + 64 * hm;
            bf16x8 qf[4];
#pragma unroll
            for (int d0 = 0; d0 < 4; ++d0) qf[d0] = *(const GAS bf16x8*)(qp + 16 * d0 + 8 * hh);
            float m = -1.0e30f, l = 0.f; f32x16 O[2]; O[0] = (f32x16){}; O[1] = (f32x16){};
            const int kpos0 = n * 256;
            const bool nearq = (pos - (kpos0 + 255)) < 113;
            if (__any(nearq)) attend<1>(kimg, vimg, qf, 0, 8, pos, kpos0, 0.f, tbl + hm * 128, r32, hh, lane, m, l, O);
            else attend<0>(kimg, vimg, qf, 0, 8, pos, kpos0, tbl[hm * 128 + 127], tbl, r32, hh, lane, m, l, O);
            if (valid) {
                const size_t pidx = ((size_t)bhm * SEQ + pos) * 3 + slot;
                if (hh == 0) { F.pml[pidx * 2] = m; F.pml[pidx * 2 + 1] = l; }
                const float rl = 1.f / l; bf16* po = F.PO + pidx * 64;
#pragma unroll
                for (int db = 0; db < 2; ++db)
#pragma unroll
                    for (int xg = 0; xg < 4; ++xg) { v2u w; w.x = pk2(O[db][4 * xg] * rl, O[db][4 * xg + 1] * rl); w.y = pk2(O[db][4 * xg + 2] * rl, O[db][4 * xg + 3] * rl);
                        *(GAS v2u*)(po + 32 * db + 8 * xg + 4 * hh) = w; }
            }
        }
        __syncthreads();
    }
}

__device__ __forceinline__ void p5_moba_own_unit(Frame& F, int u) {
    const int qb = u & 31, bhm = u >> 5, hm = bhm & 7, b = bhm >> 3;
    LAS unsigned char* kimg = F.lds + RING_OFF; LAS unsigned char* vimg = F.lds + RING_OFF + 32768;
    const LAS float* tbl = (const LAS float*)(F.lds + BIAS_OFF) + hm * 128;
    const bf16* kvb = F.PROJ + (size_t)(b * SEQ + qb * 256) * NPROJ + 64 * hm;
    stage_kv256(F, kvb + C_MK, kvb + C_MV, NPROJ, kimg, vimg);
    __syncthreads();
    const int lane = F.lane, r32 = lane & 31, hh = lane >> 5;
    const int pos = qb * 256 + 32 * F.wave + r32;
    const bf16* qp = F.PROJ + (size_t)(b * SEQ + pos) * NPROJ + C_MQ + 64 * hm;
    bf16x8 qf[4];
#pragma unroll
    for (int d0 = 0; d0 < 4; ++d0) qf[d0] = *(const GAS bf16x8*)(qp + 16 * d0 + 8 * hh);
    float m = -1.0e30f, l = 0.f; f32x16 O[2]; O[0] = (f32x16){}; O[1] = (f32x16){};
    attend<2>(kimg, vimg, qf, 0, F.wave + 1, pos, qb * 256, 0.f, tbl, r32, hh, lane, m, l, O);
    const int nsel = qb < 3 ? qb : 3;
    const size_t pidx0 = ((size_t)bhm * SEQ + pos) * 3;
    float ms[3], ls[3]; float mm = m;
#pragma unroll
    for (int s = 0; s < 3; ++s) { ms[s] = -1.0e30f; ls[s] = 0.f; if (s < nsel) { ms[s] = F.pml[(pidx0 + s) * 2]; ls[s] = F.pml[(pidx0 + s) * 2 + 1]; } mm = fmaxf(mm, ms[s]); }
    const float w0 = __builtin_amdgcn_exp2f(m - mm); float Lt = l * w0; float ws[3];
#pragma unroll
    for (int s = 0; s < 3; ++s) { ws[s] = ls[s] * __builtin_amdgcn_exp2f(ms[s] - mm); Lt += ws[s]; }
    const float rL = 1.f / Lt;
    bf16* op = F.H + (size_t)(b * SEQ + pos) * DM + 512 + 64 * hm;
#pragma unroll
    for (int db = 0; db < 2; ++db)
#pragma unroll
        for (int xg = 0; xg < 4; ++xg) { const int d = 32 * db + 8 * xg + 4 * hh; float o[4];
#pragma unroll
            for (int k = 0; k < 4; ++k) o[k] = O[db][4 * xg + k] * w0;
#pragma unroll
            for (int s = 0; s < 3; ++s) if (s < nsel) { const v2u pw = *(const GAS v2u*)(F.PO + (pidx0 + s) * 64 + d);
                o[0] += bf_lo(pw.x) * ws[s]; o[1] += bf_hi(pw.x) * ws[s]; o[2] += bf_lo(pw.y) * ws[s]; o[3] += bf_hi(pw.y) * ws[s]; }
            v2u w; w.x = pk2(o[0] * rL, o[1] * rL); w.y = pk2(o[2] * rL, o[3] * rL); *(GAS v2u*)(op + d) = w; }
    __syncthreads();
}

__device__ __forceinline__ void p7_row(const Frame& F, int m, const bf16* mix) {
    const GAS f32x4* xr = (const GAS f32x4*)(F.x + (size_t)m * DM) + F.lane; const GAS v2u* mr = (const GAS v2u*)(mix + (size_t)m * DM) + F.lane;
    const GAS f32x4* g1 = (const GAS f32x4*)F.g_post_mix + F.lane; const GAS f32x4* g2 = (const GAS f32x4*)F.g_pre_ffn + F.lane;
    f32x4 v[4]; float s = 0.f;
#pragma unroll
    for (int j = 0; j < 4; ++j) { const v2u w = mr[64 * j]; v[j] = (f32x4){bf_lo(w.x), bf_hi(w.x), bf_lo(w.y), bf_hi(w.y)}; s += (v[j].x * v[j].x + v[j].y * v[j].y) + (v[j].z * v[j].z + v[j].w * v[j].w); }
    const float rstd = 1.f / sqrtf(wave_sum(s) * (1.f / DM) + EPS);
    float s2 = 0.f; GAS f32x4* orow = (GAS f32x4*)(F.out + (size_t)m * DM) + F.lane;
#pragma unroll
    for (int j = 0; j < 4; ++j) { v[j] = xr[64 * j] + v[j] * rstd * g1[64 * j]; orow[64 * j] = v[j]; s2 += (v[j].x * v[j].x + v[j].y * v[j].y) + (v[j].z * v[j].z + v[j].w * v[j].w); }
    const float rstd2 = 1.f / sqrtf(wave_sum(s2) * (1.f / DM) + EPS);
    GAS unsigned long long* o8 = (GAS unsigned long long*)(F.H + (size_t)m * DM) + F.lane;
#pragma unroll
    for (int j = 0; j < 4; ++j) { const f32x4 gg = g2[64 * j]; o8[64 * j] = (unsigned long long)pk2(v[j].x * rstd2 * gg.x, v[j].y * rstd2 * gg.y) | ((unsigned long long)pk2(v[j].z * rstd2 * gg.z, v[j].w * rstd2 * gg.w) << 32); }
}
__device__ __forceinline__ void p10_row(const Frame& F, int m, const bf16* f) {
    GAS f32x4* orow = (GAS f32x4*)(F.out + (size_t)m * DM) + F.lane; const GAS v2u* fr = (const GAS v2u*)(f + (size_t)m * DM) + F.lane;
    const GAS f32x4* g3 = (const GAS f32x4*)F.g_post_ffn + F.lane;
    f32x4 v[4]; float s = 0.f;
#pragma unroll
    for (int j = 0; j < 4; ++j) { const v2u w = fr[64 * j]; v[j] = (f32x4){bf_lo(w.x), bf_hi(w.x), bf_lo(w.y), bf_hi(w.y)}; s += (v[j].x * v[j].x + v[j].y * v[j].y) + (v[j].z * v[j].z + v[j].w * v[j].w); }
    const float rstd = 1.f / sqrtf(wave_sum(s) * (1.f / DM) + EPS);
#pragma unroll
    for (int j = 0; j < 4; ++j) orow[64 * j] = orow[64 * j] + v[j] * rstd * g3[64 * j];
}

constexpr int NPHASE = 11;
struct Args { const float* in[11]; float* out; unsigned char* ws; int ph_lo, ph_hi; };
__global__ void __launch_bounds__(NWAVES * 64, 2) fwd_kernel(Args args) {
    extern __shared__ __attribute__((aligned(16))) unsigned char lds[];
    Frame F;
    F.lds = (LAS unsigned char*)lds;
    F.MISC = (volatile LAS unsigned*)(F.lds + MISC_OFF);
    F.tid = threadIdx.x; F.lane = F.tid & 63; F.wave = __builtin_amdgcn_readfirstlane(F.tid >> 6);
    F.G = gridDim.x; { const int bx = blockIdx.x; F.vcu = (F.G % 8 == 0) ? (bx % 8) * (F.G / 8) + bx / 8 : bx; }
    unsigned char* ws = args.ws;
    F.ctl = (gu32*)(ws + WS_CTL);
    F.x = args.in[0]; F.w_in = args.in[1]; F.w_out = args.in[2]; F.g_pre_mix = args.in[3]; F.g_post_mix = args.in[4]; F.g_pre_ffn = args.in[5]; F.g_post_ffn = args.in[6];
    F.rel_bias = args.in[7]; F.w_gate = args.in[8]; F.w_up = args.in[9]; F.w_down = args.in[10]; F.out = args.out;
    F.Win_t = (bf16*)(ws + WS_WIN); F.Wout_t = (bf16*)(ws + WS_WOUT); F.Wgu_t = (bf16*)(ws + WS_WGU); F.Wdn_t = (bf16*)(ws + WS_WDN);
    F.rope = (float*)(ws + WS_ROPE); F.kmean = (float*)(ws + WS_KMEAN); F.sst = (float*)(ws + WS_SST); F.pml = (float*)(ws + WS_PML);
    F.H = (bf16*)(ws + WS_H); F.PROJ = (bf16*)(ws + WS_PROJ); F.PST = (bf16*)(ws + WS_PST); F.PO = (bf16*)(ws + WS_PO);
    F.list = (unsigned short*)(ws + WS_LIST);
    bf16* const MIX = (bf16*)(ws + WS_PROJ); bf16* const ACT = (bf16*)(ws + WS_PROJ); bf16* const FB = (bf16*)(ws + WS_SST);
    for (int u = F.tid; u < (BIAS_OFF - LDSCTL_OFF) / 4; u += NWAVES * 64) ((LAS unsigned*)(F.lds + LDSCTL_OFF))[u] = 0u;
    build_bias_table(F);
    __syncthreads();
    const int lo = args.ph_lo, hi = args.ph_hi;
    const bool multi = (hi - lo) > 1;
    XcdBarrier bar; bar.bar = (unsigned*)(F.ctl + CW_BAR); bar.x = 0; bar.st = nullptr;
    if (multi) bar = xcd_barrier_post((unsigned*)(F.ctl + CW_BAR), F.MISC + 8);
#define IN(k) (lo <= (k) && (k) < hi)
#define SEAM(k) do { if (IN(k) && IN((k) + 1)) xcd_barrier(bar); } while (0)
    const int gw = F.vcu * NWAVES + F.wave, NGW = F.G * NWAVES;

    if (IN(0)) { p0_prologue(F); }
    SEAM(0);
    if (IN(1)) {
        pg8::Gemm g{F.H, F.Win_t, M, NPROJ, DM}; pg8::StaticOrder S; S.init(M, NPROJ, F.G, (int)blockIdx.x);
        pg8::EpiProj E{F.PROJ, NPROJ, F.rope, SEQ};
        pg8::gemm_phase<pg8::EpiProj, pg8::StaticOrder, true, true>(F.lds + RING_OFF, g, S, E);
    }
    SEAM(1);
    if (IN(2)) {
        for (int u = F.vcu; u < 2048; u += F.G) { if (u < 1024) p2_ret_state_unit(F, u); else p2_kmean_unit(F, u - 1024); }
    }
    SEAM(2);
    if (IN(3)) {
        p3_scan(F);
        for (int u = F.vcu; u < 1024; u += F.G) { if ((u & 31) != 0) p3_topk_unit(F, u); }
    }
    SEAM(3);
    if (IN(4)) {
        for (int u = F.vcu; u < 512; u += F.G) p4_ret_out_unit(F, u);
        p4_moba_sel(F);
    }
    SEAM(4);
    if (IN(5)) {
        for (int u = F.vcu; u < 1024; u += F.G) p5_moba_own_unit(F, u);
    }
    SEAM(5);
    if (IN(6)) {
        pg8::Gemm g{F.H, F.Wout_t, M, DM, DM}; pg8::StaticOrder S; S.init(M, DM, F.G, (int)blockIdx.x);
        pg8::EpiPlain E{MIX, DM};
        pg8::gemm_phase<pg8::EpiPlain, pg8::StaticOrder, true, true>(F.lds + RING_OFF, g, S, E);
    }
    SEAM(6);
    if (IN(7)) { for (int m = gw; m < M; m += NGW) p7_row(F, m, MIX); }
    SEAM(7);
    if (IN(8)) {
        pg8::Gemm g{F.H, F.Wgu_t, M, NGU, DM}; pg8::StaticOrder S; S.init(M, NGU, F.G, (int)blockIdx.x);
        pg8::EpiSwiGLU E{ACT, DFF};
        pg8::gemm_phase<pg8::EpiSwiGLU, pg8::StaticOrder, true, true>(F.lds + RING_OFF, g, S, E);
    }
    SEAM(8);
    if (IN(9)) {
        pg8::Gemm g{ACT, F.Wdn_t, M, DM, DFF}; pg8::StaticOrder S; S.init(M, DM, F.G, (int)blockIdx.x);
        pg8::EpiPlain E{FB, DM};
        pg8::gemm_phase<pg8::EpiPlain, pg8::StaticOrder, true, true>(F.lds + RING_OFF, g, S, E);
    }
    SEAM(9);
    if (IN(10)) { for (int m = gw; m < M; m += NGW) p10_row(F, m, FB); }
#undef IN
#undef SEAM
}

#ifndef MK_ONE_LAUNCH
#define MK_ONE_LAUNCH 0
#endif
extern "C" void kernel_launch(void* const* d_in, const int* in_sizes, int n_in, void* d_out, int out_size, void* d_ws, size_t ws_size, hipStream_t stream) {
    static int grid = 0;
    if (grid == 0) {
        if (n_in != 11 || in_sizes[0] != M * DM || out_size != M * DM || ws_size < WS_END) { fprintf(stderr, "kernel_launch: unexpected shapes / workspace (n_in %d, in0 %d, out %d, ws %zu)\n", n_in, n_in > 0 ? in_sizes[0] : -1, out_size, ws_size); grid = -1; return; }
        int dev = 0, cus = 0, per_cu = 0;
        if (hipGetDevice(&dev) != hipSuccess || hipDeviceGetAttribute(&cus, hipDeviceAttributeMultiprocessorCount, dev) != hipSuccess) { grid = -1; return; }
        if (hipFuncSetAttribute((const void*)fwd_kernel, hipFuncAttributeMaxDynamicSharedMemorySize, LDS_BYTES) != hipSuccess) { fprintf(stderr, "kernel_launch: hipFuncSetAttribute failed\n"); grid = -1; return; }
        if (hipOccupancyMaxActiveBlocksPerMultiprocessor(&per_cu, (const void*)fwd_kernel, NWAVES * 64, LDS_BYTES) != hipSuccess || per_cu < 1) { fprintf(stderr, "kernel_launch: occupancy query reports %d\n", per_cu); }
        (void)hipGetLastError();
        grid = cus;
    }
    if (grid < 0) return;
    if (hipMemsetAsync((char*)d_ws + WS_CTL, 0, CTL_ZERO_BYTES, stream) != hipSuccess) return;
    Args a{};
    for (int i = 0; i < 11; ++i) a.in[i] = (const float*)d_in[i];
    a.out = (float*)d_out; a.ws = (unsigned char*)d_ws;
#if MK_ONE_LAUNCH
    a.ph_lo = 0; a.ph_hi = NPHASE;
    hipLaunchKernelGGL(fwd_kernel, dim3(grid), dim3(NWAVES * 64), LDS_BYTES, stream, a);
#else
    for (int p = 0; p < NPHASE; ++p) { a.ph_lo = p; a.ph_hi = p + 1; hipLaunchKernelGGL(fwd_kernel, dim3(grid), dim3(NWAVES * 64), LDS_BYTES, stream, a); }
#endif
}
```
